# Optimizing an MI355X kernel written in HIP

```python
import jax, jax.numpy as jnp
from jax import lax
import numpy as np

D_MODEL = 1024
BATCH = 8
SEQ = 2048
DEPTH = 1

CHUNK = 64
Q_BLOCK = 128
EPS = 1e-6

SB_HEADS = 8
SB_HEAD_DIM = 64
SB_WIDTH = SB_HEADS * SB_HEAD_DIM

DF_HEADS = 4
DF_HEAD_DIM = 64
DF_V_DIM = 2 * DF_HEAD_DIM
DF_WIDTH = DF_HEADS * DF_V_DIM
DF_QK_WIDTH = DF_HEADS * 2 * DF_HEAD_DIM

N_BRANCH = 2
IN_SIZES = (SB_WIDTH, SB_WIDTH, SB_WIDTH, SB_WIDTH,
            DF_QK_WIDTH, DF_QK_WIDTH, DF_WIDTH, DF_WIDTH)
IN_COLS = sum(IN_SIZES)
IN_SPLITS = tuple(int(v) for v in np.cumsum(IN_SIZES)[:-1])

kernel_name = "hybrid_stickbreak_diffattn_block"


def rmsnorm(x, gain):
    xf = x.astype(jnp.float32)
    y = xf * lax.rsqrt(jnp.mean(xf * xf, axis=-1, keepdims=True) + EPS)
    return (y * gain.astype(jnp.float32)).astype(x.dtype)


def alibi_slopes(n_heads):
    return np.array([2.0 ** (-8.0 * (h + 1) / n_heads) for h in range(n_heads)], dtype=np.float32)


def stick_breaking_attention(q, k, v):
    s_len, d = q.shape[1], q.shape[3]
    scale = d ** -0.5
    outs = []
    for i0 in range(0, s_len, Q_BLOCK):
        i1 = i0 + Q_BLOCK
        qb, kb, vb = q[:, i0:i1], k[:, :i1], v[:, :i1]
        z = jnp.einsum('bqhd,bkhd->bhqk', qb, kb).astype(jnp.float32) * scale
        t_idx = np.arange(i0, i1)[:, None]
        s_idx = np.arange(i1)[None, :]
        strict = s_idx < t_idx
        log_keep = jnp.where(strict, jax.nn.log_sigmoid(-z), 0.0)
        after = lax.cumsum(log_keep, axis=3, reverse=True) - log_keep
        w = jnp.where(strict, jnp.exp(jax.nn.log_sigmoid(z) + after), 0.0)
        outs.append(jnp.einsum('bhqk,bkhd->bqhd', w.astype(v.dtype), vb))
    return jnp.concatenate(outs, axis=1)


def differential_attention(q, k, v, lam, head_gain, lambda_init):
    s_len, n_heads, d = q.shape[1], q.shape[2], q.shape[4]
    scale = d ** -0.5
    slopes = alibi_slopes(n_heads)[:, None, None]
    outs = []
    for i0 in range(0, s_len, Q_BLOCK):
        i1 = i0 + Q_BLOCK
        qb, kb, vb = q[:, i0:i1], k[:, :i1], v[:, :i1]
        logits = jnp.einsum('bqhcd,bkhcd->bchqk', qb, kb).astype(jnp.float32) * scale
        t_idx = np.arange(i0, i1)[:, None]
        s_idx = np.arange(i1)[None, :]
        dist = np.abs(t_idx - s_idx).astype(np.float32)
        chunk_mask = (s_idx // CHUNK) <= (t_idx // CHUNK)
        logits = jnp.where(chunk_mask, logits - slopes * dist, -jnp.inf)
        p = jax.nn.softmax(logits, axis=-1)
        w = p[:, 0] - lam * p[:, 1]
        outs.append(jnp.einsum('bhqk,bkhe->bqhe', w.astype(v.dtype), vb))
    o = jnp.concatenate(outs, axis=1)
    return rmsnorm(o, head_gain) * (1.0 - lambda_init)


def setup_inputs(seed: int = 0) -> dict:
    key = jax.random.key(seed)
    ks = jax.random.split(key, 14)
    f32 = jnp.float32
    nrm = lambda k, shape, s: jax.random.normal(k, shape, f32) * s
    return {
        "x": jax.random.normal(ks[0], (BATCH, SEQ, D_MODEL), f32),
        "norm_pre": 1.0 + nrm(ks[1], (DEPTH, D_MODEL), 0.02),
        "norm_post": 1.0 + nrm(ks[2], (DEPTH, D_MODEL), 0.02),
        "w_in": nrm(ks[3], (DEPTH, D_MODEL, IN_COLS), D_MODEL ** -0.5),
        "w_gate": nrm(ks[4], (DEPTH, D_MODEL, N_BRANCH * D_MODEL), D_MODEL ** -0.5),
        "b_gate": nrm(ks[5], (DEPTH, N_BRANCH * D_MODEL), 0.01),
        "w_branch_sb": nrm(ks[6], (DEPTH, SB_WIDTH, D_MODEL), SB_WIDTH ** -0.5),
        "w_branch_df": nrm(ks[7], (DEPTH, DF_WIDTH, D_MODEL), DF_WIDTH ** -0.5),
        "w_out": nrm(ks[8], (DEPTH, D_MODEL, D_MODEL), D_MODEL ** -0.5),
        "lambda_q": nrm(ks[9], (DEPTH, 2, DF_HEAD_DIM), 0.1),
        "lambda_k": nrm(ks[10], (DEPTH, 2, DF_HEAD_DIM), 0.1),
        "df_head_norm": 1.0 + nrm(ks[11], (DEPTH, DF_V_DIM), 0.02),
    }


def reference(x, norm_pre, norm_post, w_in, w_gate, b_gate, w_branch_sb, w_branch_df,
              w_out, lambda_q, lambda_k, df_head_norm):
    b, s, _ = x.shape
    for l in range(DEPTH):
        lambda_init = 0.8 - 0.6 * float(np.exp(-0.3 * l))
        h = rmsnorm(x, norm_pre[l])
        proj = h @ w_in[l]
        sb_q, sb_k, sb_v, sb_z, df_q, df_k, df_v, df_z = jnp.split(proj, IN_SPLITS, axis=-1)

        sb_shape = (b, s, SB_HEADS, SB_HEAD_DIM)
        o_sb = stick_breaking_attention(sb_q.reshape(sb_shape), sb_k.reshape(sb_shape),
                                        sb_v.reshape(sb_shape)).reshape(b, s, SB_WIDTH)
        y_sb = (o_sb * jax.nn.silu(sb_z)) @ w_branch_sb[l]

        lq = lambda_q[l].astype(jnp.float32)
        lk = lambda_k[l].astype(jnp.float32)
        lam = jnp.exp(jnp.sum(lq[0] * lk[0])) - jnp.exp(jnp.sum(lq[1] * lk[1])) + lambda_init
        qk_shape = (b, s, DF_HEADS, 2, DF_HEAD_DIM)
        o_df = differential_attention(df_q.reshape(qk_shape), df_k.reshape(qk_shape),
                                      df_v.reshape(b, s, DF_HEADS, DF_V_DIM), lam,
                                      df_head_norm[l], lambda_init).reshape(b, s, DF_WIDTH)
        y_df = (o_df * jax.nn.silu(df_z)) @ w_branch_df[l]

        gates = jax.nn.sigmoid(h @ w_gate[l] + b_gate[l])
        g_sb, g_df = jnp.split(gates, N_BRANCH, axis=-1)
        out = (g_sb * y_sb + g_df * y_df) @ w_out[l]
        x = x + rmsnorm(out, norm_post[l])
    return x
```

```cpp
#include <hip/hip_runtime.h>
#include <cstdint>
#include <cstdio>

#define GAS __attribute__((address_space(1)))
#define LAS __attribute__((address_space(3)))
typedef unsigned short bf16;
typedef short bf16x8 __attribute__((ext_vector_type(8)));
typedef float f32x4 __attribute__((ext_vector_type(4)));
typedef float f32x16 __attribute__((ext_vector_type(16)));
typedef unsigned v4u __attribute__((ext_vector_type(4)));
typedef unsigned v2u __attribute__((ext_vector_type(2)));

constexpr int NWAVES = 8;
constexpr int BATCH = 8, SEQ = 2048, DM = 1024, T = BATCH * SEQ;
constexpr int NPROJ = 4096, NGATE = 2048, NCOMB = NPROJ + NGATE;
constexpr int SBH = 8, DFH = 4, HD = 64;
constexpr float EPS = 1e-6f;
constexpr float LAMBDA_INIT = 0.2f;
constexpr int C_SBQ = 0, C_SBK = 512, C_SBV = 1024, C_SBZ = 1536, C_DFQ = 2048, C_DFK = 2560, C_DFV = 3072, C_DFZ = 3584;

constexpr size_t MiB = 1u << 20;
constexpr size_t WS_CTL = 0, CTL_ZERO_BYTES = 1 * MiB;
constexpr size_t WS_W1T = 2 * MiB;
constexpr size_t WS_WSB = 14 * MiB;
constexpr size_t WS_WDF = 15 * MiB;
constexpr size_t WS_WOUT = 16 * MiB;
constexpr size_t WS_XCH = 18 * MiB;
constexpr size_t WS_PROJ = 20 * MiB;
constexpr size_t WS_GATES = 148 * MiB;
constexpr size_t WS_M = 212 * MiB;
constexpr size_t WS_END = 244 * MiB;
constexpr size_t DO_H = 0, DO_USB = 32 * MiB, DO_UDF = 48 * MiB;

constexpr int LDS_BYTES = 147456;

__device__ __forceinline__ float bf2f(unsigned b) { return __uint_as_float(b << 16); }
__device__ __forceinline__ unsigned f2bf(float f) { unsigned u = __float_as_uint(f); return (u + 0x7fffu + ((u >> 16) & 1u)) >> 16; }
__device__ __forceinline__ unsigned pk2(float lo, float hi) { return f2bf(lo) | (f2bf(hi) << 16); }
#define LDS_WAIT() asm volatile("s_waitcnt lgkmcnt(0)" ::: "memory")

__device__ __forceinline__ float wave_sum(float v) {
#pragma unroll
    for (int o = 1; o < 64; o <<= 1) v += __shfl_xor(v, o);
    return v;
}

struct Frame {
    LAS unsigned char* lds;
    int tid, lane, wave, vcu, G;
    const float *x, *norm_pre, *norm_post, *w_in, *w_gate, *b_gate, *w_sb, *w_df, *w_out, *lam_q, *lam_k, *df_gain;
    float* out;
    bf16 *W1T, *WSBT, *WDFT, *WOUTT, *PROJ, *GATES, *MB, *HB, *USB, *UDF;
};

__device__ __forceinline__ void p0_transpose_item(const float* W, int K, int N, bf16* WT, int row_off, LAS float* scr, int item, int lane) {
    const int nblk = N / 32, kb = item / nblk, nb = item % nblk, k0 = 64 * kb, n0 = 32 * nb;
#pragma unroll 8
    for (int i = 0; i < 32; ++i) { const int kk = 2 * i + (lane >> 5); scr[kk * 33 + (lane & 31)] = W[(size_t)(k0 + kk) * N + n0 + (lane & 31)]; }
    LDS_WAIT(); asm volatile("" ::: "memory");
    const int c = lane & 7;
#pragma unroll
    for (int j = 0; j < 4; ++j) { const int n = (lane >> 3) + 8 * j; const LAS float* s = scr + (8 * c) * 33 + n;
        v4u o; o.x = pk2(s[0 * 33], s[1 * 33]); o.y = pk2(s[2 * 33], s[3 * 33]); o.z = pk2(s[4 * 33], s[5 * 33]); o.w = pk2(s[6 * 33], s[7 * 33]);
        *(GAS v4u*)(WT + (size_t)(row_off + n0 + n) * K + k0 + 8 * c) = o; }
    LDS_WAIT(); asm volatile("" ::: "memory");
}
__device__ __forceinline__ void rms_row_to_bf16(Frame& F, const float* xrow, bf16* orow) {
    const GAS f32x4* xr = (const GAS f32x4*)xrow + F.lane;
    const GAS f32x4* gr = (const GAS f32x4*)F.norm_pre + F.lane;
    f32x4 v[4]; float s2 = 0.f;
#pragma unroll
    for (int j = 0; j < 4; ++j) { v[j] = xr[64 * j]; s2 += (v[j].x * v[j].x + v[j].y * v[j].y) + (v[j].z * v[j].z + v[j].w * v[j].w); }
    const float r = 1.f / sqrtf(wave_sum(s2) * (1.f / DM) + EPS);
    GAS unsigned long long* o8 = (GAS unsigned long long*)orow + F.lane;
#pragma unroll
    for (int j = 0; j < 4; ++j) { const f32x4 g = gr[64 * j];
        o8[64 * j] = (unsigned long long)pk2(v[j].x * r * g.x, v[j].y * r * g.y) | ((unsigned long long)pk2(v[j].z * r * g.z, v[j].w * r * g.w) << 32); }
}
__device__ __forceinline__ void p0_prologue(Frame& F) {
    LAS float* scr = (LAS float*)(F.lds + F.wave * 16384);
    const int gw = F.vcu * NWAVES + F.wave, NGW = F.G * NWAVES;
    constexpr int I_IN = (DM / 64) * (NPROJ / 32), I_G = (DM / 64) * (NGATE / 32), I_B = (512 / 64) * (DM / 32), I_O = (DM / 64) * (DM / 32);
    constexpr int NITEMS = I_IN + I_G + 2 * I_B + I_O;
    for (int it = gw; it < NITEMS; it += NGW) {
        int r = it;
        if (r < I_IN) { p0_transpose_item(F.w_in, DM, NPROJ, F.W1T, 0, scr, r, F.lane); continue; } r -= I_IN;
        if (r < I_G) { p0_transpose_item(F.w_gate, DM, NGATE, F.W1T, NPROJ, scr, r, F.lane); continue; } r -= I_G;
        if (r < I_B) { p0_transpose_item(F.w_sb, 512, DM, F.WSBT, 0, scr, r, F.lane); continue; } r -= I_B;
        if (r < I_B) { p0_transpose_item(F.w_df, 512, DM, F.WDFT, 0, scr, r, F.lane); continue; } r -= I_B;
        p0_transpose_item(F.w_out, DM, DM, F.WOUTT, 0, scr, r, F.lane);
    }
    for (int m = gw; m < T; m += NGW) rms_row_to_bf16(F, F.x + (size_t)m * DM, F.HB + (size_t)m * DM);
}

__device__ __forceinline__ int crow(int r, int hi) { return (r & 3) + 8 * (r >> 2) + 4 * hi; }
template <class Epi>
__device__ __forceinline__ void naive_gemm(Frame& F, const bf16* A, int lda, const bf16* Bt, int ldb, int M, int N, int K, const Epi& epi) {
    const int gw = F.vcu * NWAVES + F.wave, NGW = F.G * NWAVES, lane = F.lane, r32 = lane & 31, hi = lane >> 5;
    const int tilesN = N / 32, tiles = (M / 32) * tilesN;
    for (int tile = gw; tile < tiles; tile += NGW) {
        const int tm = tile / tilesN, tn = tile % tilesN;
        const bf16* ap = A + (size_t)(tm * 32 + r32) * lda + hi * 8;
        const bf16* bp = Bt + (size_t)(tn * 32 + r32) * ldb + hi * 8;
        f32x16 acc = {0.f, 0.f, 0.f, 0.f, 0.f, 0.f, 0.f, 0.f, 0.f, 0.f, 0.f, 0.f, 0.f, 0.f, 0.f, 0.f};
        for (int k = 0; k < K; k += 16) {
            const bf16x8 a = *(const GAS bf16x8*)(ap + k), b = *(const GAS bf16x8*)(bp + k);
            acc = __builtin_amdgcn_mfma_f32_32x32x16_bf16(a, b, acc, 0, 0, 0);
        }
#pragma unroll
        for (int r = 0; r < 16; ++r) epi(tm * 32 + crow(r, hi), tn * 32 + r32, acc[r]);
    }
}
struct EpiProj {
    bf16* proj; bf16* gates; const float* bg;
    __device__ __forceinline__ void operator()(int row, int col, float v) const {
        if (col < NPROJ) proj[(size_t)row * NPROJ + col] = (bf16)f2bf(v);
        else { const int c = col - NPROJ; const float z = v + bg[c]; gates[(size_t)row * NGATE + c] = (bf16)f2bf(1.f / (1.f + expf(-z))); }
    }
};
struct EpiF32 { float* o; int ld; __device__ __forceinline__ void operator()(int row, int col, float v) const { o[(size_t)row * ld + col] = v; } };

__device__ __forceinline__ void naive_p3(Frame& F) {
    const int gw = F.vcu * NWAVES + F.wave, NGW = F.G * NWAVES, lane = F.lane, r32 = lane & 31, hi = lane >> 5;
    const int tilesN = DM / 32, tiles = (T / 32) * tilesN;
    for (int tile = gw; tile < tiles; tile += NGW) {
        const int tm = tile / tilesN, tn = tile % tilesN;
        const bf16* a1 = F.USB + (size_t)(tm * 32 + r32) * 512 + hi * 8; const bf16* b1 = F.WSBT + (size_t)(tn * 32 + r32) * 512 + hi * 8;
        const bf16* a2 = F.UDF + (size_t)(tm * 32 + r32) * 512 + hi * 8; const bf16* b2 = F.WDFT + (size_t)(tn * 32 + r32) * 512 + hi * 8;
        f32x16 acc1 = {0.f, 0.f, 0.f, 0.f, 0.f, 0.f, 0.f, 0.f, 0.f, 0.f, 0.f, 0.f, 0.f, 0.f, 0.f, 0.f}, acc2 = acc1;
        for (int k = 0; k < 512; k += 16) {
            acc1 = __builtin_amdgcn_mfma_f32_32x32x16_bf16(*(const GAS bf16x8*)(a1 + k), *(const GAS bf16x8*)(b1 + k), acc1, 0, 0, 0);
            acc2 = __builtin_amdgcn_mfma_f32_32x32x16_bf16(*(const GAS bf16x8*)(a2 + k), *(const GAS bf16x8*)(b2 + k), acc2, 0, 0, 0);
        }
#pragma unroll
        for (int r = 0; r < 16; ++r) { const int row = tm * 32 + crow(r, hi), col = tn * 32 + r32;
            const float gs = bf2f(F.GATES[(size_t)row * NGATE + col]), gd = bf2f(F.GATES[(size_t)row * NGATE + DM + col]);
            F.MB[(size_t)row * DM + col] = (bf16)f2bf(gs * acc1[r] + gd * acc2[r]); }
    }
}

__device__ __forceinline__ void naive_sb_item(Frame& F, int b, int h, int qb) {
    const int lane = F.lane, q0 = qb * 64, t = q0 + lane;
    const bf16* base = F.PROJ + (size_t)b * SEQ * NPROJ;
    float q[64], acc[64];
    { const bf16* qp = base + (size_t)t * NPROJ + C_SBQ + h * 64;
#pragma unroll
      for (int d = 0; d < 64; d += 8) { const v4u w = *(const GAS v4u*)(qp + d);
          q[d] = bf2f(w.x & 0xffffu); q[d + 1] = bf2f(w.x >> 16); q[d + 2] = bf2f(w.y & 0xffffu); q[d + 3] = bf2f(w.y >> 16);
          q[d + 4] = bf2f(w.z & 0xffffu); q[d + 5] = bf2f(w.z >> 16); q[d + 6] = bf2f(w.w & 0xffffu); q[d + 7] = bf2f(w.w >> 16); } }
#pragma unroll
    for (int d = 0; d < 64; ++d) acc[d] = 0.f;
    float R = 0.f;
    for (int s = q0 + 62; s >= 0; --s) {
        const bf16* kp = base + (size_t)s * NPROJ + C_SBK + h * 64; const bf16* vp = base + (size_t)s * NPROJ + C_SBV + h * 64;
        float z = 0.f;
#pragma unroll
        for (int d = 0; d < 64; d += 8) { const v4u w = *(const GAS v4u*)(kp + d);
            z += q[d] * bf2f(w.x & 0xffffu); z += q[d + 1] * bf2f(w.x >> 16); z += q[d + 2] * bf2f(w.y & 0xffffu); z += q[d + 3] * bf2f(w.y >> 16);
            z += q[d + 4] * bf2f(w.z & 0xffffu); z += q[d + 5] * bf2f(w.z >> 16); z += q[d + 6] * bf2f(w.w & 0xffffu); z += q[d + 7] * bf2f(w.w >> 16); }
        z *= 0.125f;
        const float sp = fmaxf(z, 0.f) + log1pf(expf(-fabsf(z)));
        const bool on = s < t;
        const float w = on ? expf((z - sp) + R) : 0.f;
        if (on) R -= sp;
#pragma unroll
        for (int d = 0; d < 64; d += 8) { const v4u u = *(const GAS v4u*)(vp + d);
            acc[d] += w * bf2f(u.x & 0xffffu); acc[d + 1] += w * bf2f(u.x >> 16); acc[d + 2] += w * bf2f(u.y & 0xffffu); acc[d + 3] += w * bf2f(u.y >> 16);
            acc[d + 4] += w * bf2f(u.z & 0xffffu); acc[d + 5] += w * bf2f(u.z >> 16); acc[d + 6] += w * bf2f(u.w & 0xffffu); acc[d + 7] += w * bf2f(u.w >> 16); }
    }
    const bf16* zp = base + (size_t)t * NPROJ + C_SBZ + h * 64;
    bf16* up = F.USB + ((size_t)b * SEQ + t) * 512 + h * 64;
#pragma unroll
    for (int d = 0; d < 64; d += 2) { const unsigned zz = *(const GAS unsigned*)(zp + d); const float z0 = bf2f(zz & 0xffffu), z1 = bf2f(zz >> 16);
        *(GAS unsigned*)(up + d) = pk2(acc[d] * z0 / (1.f + expf(-z0)), acc[d + 1] * z1 / (1.f + expf(-z1))); }
}

__device__ __forceinline__ void naive_df_item(Frame& F, int b, int h, int qb32, float lam) {
    const int lane = F.lane, c = lane & 1, t = qb32 * 32 + (lane >> 1), nk = ((qb32 >> 1) + 1) * 64;
    const bf16* base = F.PROJ + (size_t)b * SEQ * NPROJ;
    const float slope = exp2f(-2.f * (float)(h + 1));
    float q[64];
    { const bf16* p = base + (size_t)t * NPROJ + C_DFQ + h * 128 + c * 64;
#pragma unroll
      for (int d = 0; d < 64; d += 8) { const v4u w = *(const GAS v4u*)(p + d);
          q[d] = bf2f(w.x & 0xffffu); q[d + 1] = bf2f(w.x >> 16); q[d + 2] = bf2f(w.y & 0xffffu); q[d + 3] = bf2f(w.y >> 16);
          q[d + 4] = bf2f(w.z & 0xffffu); q[d + 5] = bf2f(w.z >> 16); q[d + 6] = bf2f(w.w & 0xffffu); q[d + 7] = bf2f(w.w >> 16); } }
    float m0 = -INFINITY, l0 = 0.f, m1 = -INFINITY, l1 = 0.f;
    for (int s = 0; s < nk; ++s) {
        const bf16* kp = base + (size_t)s * NPROJ + C_DFK + h * 128 + c * 64;
        float z = 0.f;
#pragma unroll
        for (int d = 0; d < 64; d += 8) { const v4u w = *(const GAS v4u*)(kp + d);
            z += q[d] * bf2f(w.x & 0xffffu); z += q[d + 1] * bf2f(w.x >> 16); z += q[d + 2] * bf2f(w.y & 0xffffu); z += q[d + 3] * bf2f(w.y >> 16);
            z += q[d + 4] * bf2f(w.z & 0xffffu); z += q[d + 5] * bf2f(w.z >> 16); z += q[d + 6] * bf2f(w.w & 0xffffu); z += q[d + 7] * bf2f(w.w >> 16); }
        z = z * 0.125f - slope * fabsf((float)(t - s));
        const float zo = __shfl_xor(z, 1);
        const float z0 = c ? zo : z, z1 = c ? z : zo;
        { const float mn = fmaxf(m0, z0); l0 = l0 * expf(m0 - mn) + expf(z0 - mn); m0 = mn; }
        { const float mn = fmaxf(m1, z1); l1 = l1 * expf(m1 - mn) + expf(z1 - mn); m1 = mn; }
    }
    const float il0 = 1.f / l0, il1 = lam / l1;
    float acc[64];
#pragma unroll
    for (int e = 0; e < 64; ++e) acc[e] = 0.f;
    for (int s = 0; s < nk; ++s) {
        const bf16* kp = base + (size_t)s * NPROJ + C_DFK + h * 128 + c * 64; const bf16* vp = base + (size_t)s * NPROJ + C_DFV + h * 128 + c * 64;
        float z = 0.f;
#pragma unroll
        for (int d = 0; d < 64; d += 8) { const v4u w = *(const GAS v4u*)(kp + d);
            z += q[d] * bf2f(w.x & 0xffffu); z += q[d + 1] * bf2f(w.x >> 16); z += q[d + 2] * bf2f(w.y & 0xffffu); z += q[d + 3] * bf2f(w.y >> 16);
            z += q[d + 4] * bf2f(w.z & 0xffffu); z += q[d + 5] * bf2f(w.z >> 16); z += q[d + 6] * bf2f(w.w & 0xffffu); z += q[d + 7] * bf2f(w.w >> 16); }
        z = z * 0.125f - slope * fabsf((float)(t - s));
        const float zo = __shfl_xor(z, 1);
        const float z0 = c ? zo : z, z1 = c ? z : zo;
        const float w = expf(z0 - m0) * il0 - expf(z1 - m1) * il1;
#pragma unroll
        for (int e = 0; e < 64; e += 8) { const v4u u = *(const GAS v4u*)(vp + e);
            acc[e] += w * bf2f(u.x & 0xffffu); acc[e + 1] += w * bf2f(u.x >> 16); acc[e + 2] += w * bf2f(u.y & 0xffffu); acc[e + 3] += w * bf2f(u.y >> 16);
            acc[e + 4] += w * bf2f(u.z & 0xffffu); acc[e + 5] += w * bf2f(u.z >> 16); acc[e + 6] += w * bf2f(u.w & 0xffffu); acc[e + 7] += w * bf2f(u.w >> 16); }
    }
    float ss = 0.f;
#pragma unroll
    for (int e = 0; e < 64; ++e) ss += acc[e] * acc[e];
    ss += __shfl_xor(ss, 1);
    const float r = (1.f - LAMBDA_INIT) / sqrtf(ss * (1.f / 128.f) + EPS);
    const bf16* zp = base + (size_t)t * NPROJ + C_DFZ + h * 128 + c * 64;
    bf16* up = F.UDF + ((size_t)b * SEQ + t) * 512 + h * 128 + c * 64;
    const float* gp = F.df_gain + c * 64;
#pragma unroll
    for (int e = 0; e < 64; e += 2) { const unsigned zz = *(const GAS unsigned*)(zp + e); const float z0 = bf2f(zz & 0xffffu), z1 = bf2f(zz >> 16);
        const float o0 = acc[e] * r * gp[e], o1 = acc[e + 1] * r * gp[e + 1];
        *(GAS unsigned*)(up + e) = pk2(o0 * z0 / (1.f + expf(-z0)), o1 * z1 / (1.f + expf(-z1))); }
}
__device__ __forceinline__ float compute_lam(Frame& F) {
    float s0 = 0.f, s1 = 0.f;
    for (int d = 0; d < 64; ++d) { s0 += F.lam_q[d] * F.lam_k[d]; s1 += F.lam_q[64 + d] * F.lam_k[64 + d]; }
    return expf(s0) - expf(s1) + LAMBDA_INIT;
}
__device__ __forceinline__ void naive_attn(Frame& F) {
    const int gw = F.vcu * NWAVES + F.wave, NGW = F.G * NWAVES;
    const float lam = compute_lam(F);
    constexpr int NIT = 32 * 128;
    for (int it = gw; it < NIT; it += NGW) {
        const int ql = 31 - (it >> 7), r = it & 127;
        if (r < 64) naive_sb_item(F, r >> 3, r & 7, ql);
        else { const int rr = r - 64; naive_df_item(F, rr >> 3, (rr >> 1) & 3, ql * 2 + (rr & 1), lam); }
    }
}

__device__ __forceinline__ void naive_final(Frame& F) {
    const int gw = F.vcu * NWAVES + F.wave, NGW = F.G * NWAVES;
    for (int m = gw; m < T; m += NGW) {
        GAS f32x4* orow = (GAS f32x4*)(F.out + (size_t)m * DM) + F.lane;
        const GAS f32x4* xr = (const GAS f32x4*)(F.x + (size_t)m * DM) + F.lane;
        const GAS f32x4* gr = (const GAS f32x4*)F.norm_post + F.lane;
        f32x4 v[4]; float s2 = 0.f;
#pragma unroll
        for (int j = 0; j < 4; ++j) { v[j] = orow[64 * j]; s2 += (v[j].x * v[j].x + v[j].y * v[j].y) + (v[j].z * v[j].z + v[j].w * v[j].w); }
        const float r = 1.f / sqrtf(wave_sum(s2) * (1.f / DM) + EPS);
#pragma unroll
        for (int j = 0; j < 4; ++j) orow[64 * j] = xr[64 * j] + v[j] * r * gr[64 * j];
    }
}

struct Args { const float* in[12]; float* out; unsigned char* ws; int ph_lo, ph_hi; };
__global__ void __launch_bounds__(NWAVES * 64, 2) fwd(Args args) {
    extern __shared__ __attribute__((aligned(16))) unsigned char lds[];
    Frame F;
    F.lds = (LAS unsigned char*)lds;
    F.tid = threadIdx.x; F.lane = F.tid & 63; F.wave = __builtin_amdgcn_readfirstlane(F.tid >> 6);
    F.G = gridDim.x; { const int bx = blockIdx.x; F.vcu = (F.G % 8 == 0) ? (bx % 8) * (F.G / 8) + bx / 8 : bx; }
    F.x = args.in[0]; F.norm_pre = args.in[1]; F.norm_post = args.in[2]; F.w_in = args.in[3]; F.w_gate = args.in[4]; F.b_gate = args.in[5];
    F.w_sb = args.in[6]; F.w_df = args.in[7]; F.w_out = args.in[8]; F.lam_q = args.in[9]; F.lam_k = args.in[10]; F.df_gain = args.in[11];
    F.out = args.out;
    unsigned char* ws = args.ws;
    F.W1T = (bf16*)(ws + WS_W1T); F.WSBT = (bf16*)(ws + WS_WSB); F.WDFT = (bf16*)(ws + WS_WDF); F.WOUTT = (bf16*)(ws + WS_WOUT);
    F.PROJ = (bf16*)(ws + WS_PROJ); F.GATES = (bf16*)(ws + WS_GATES); F.MB = (bf16*)(ws + WS_M);
    F.HB = (bf16*)((unsigned char*)args.out + DO_H); F.USB = (bf16*)((unsigned char*)args.out + DO_USB); F.UDF = (bf16*)((unsigned char*)args.out + DO_UDF);
    const int lo = args.ph_lo, hi = args.ph_hi;
#define IN(k) (lo <= (k) && (k) < hi)
    if (IN(0)) p0_prologue(F);
    if (IN(1)) { EpiProj e{F.PROJ, F.GATES, F.b_gate}; naive_gemm(F, F.HB, DM, F.W1T, DM, T, NCOMB, DM, e); }
    if (IN(2)) naive_attn(F);
    if (IN(3)) naive_p3(F);
    if (IN(4)) { EpiF32 e{F.out, DM}; naive_gemm(F, F.MB, DM, F.WOUTT, DM, T, DM, DM, e); }
    if (IN(5)) naive_final(F);
#undef IN
}

extern "C" void kernel_launch(void* const* d_in, const int* in_sizes, int n_in, void* d_out, int out_size, void* d_ws, size_t ws_size, hipStream_t stream) {
    static int grid = 0;
    if (grid == 0) {
        if (n_in != 12 || in_sizes[0] != T * DM || out_size != T * DM || ws_size < WS_END) { fprintf(stderr, "kernel_launch: unexpected shapes (n_in %d, in0 %d, out %d, ws %zu)\n", n_in, n_in > 0 ? in_sizes[0] : -1, out_size, ws_size); grid = -1; return; }
        int dev = 0, cus = 0;
        if (hipGetDevice(&dev) != hipSuccess || hipDeviceGetAttribute(&cus, hipDeviceAttributeMultiprocessorCount, dev) != hipSuccess) { grid = -1; return; }
        if (hipFuncSetAttribute((const void*)fwd, hipFuncAttributeMaxDynamicSharedMemorySize, LDS_BYTES) != hipSuccess) { fprintf(stderr, "kernel_launch: hipFuncSetAttribute failed\n"); grid = -1; return; }
        grid = cus;
    }
    if (grid < 0) return;
    Args a{};
    for (int i = 0; i < 12; ++i) a.in[i] = (const float*)d_in[i];
    a.out = (float*)d_out; a.ws = (unsigned char*)d_ws;
    for (int p = 0; p < 6; ++p) { a.ph_lo = p; a.ph_hi = p + 1; hipLaunchKernelGGL(fwd, dim3(grid), dim3(NWAVES * 64), LDS_BYTES, stream, a); }
}
```
